# Optimizing an MI355X kernel written in HIP

```python
import jax, jax.numpy as jnp
from jax import lax
import numpy as np

D_MODEL = 1024
BATCH = 2
SEQ = 8192
DEPTH = 2
DEC_BATCH = 128
DEC_SEQ = 8
PAST_LEN = 16384
PAGE_SIZE = 128

N_A_LAYERS = DEPTH // 2
N_B_LAYERS = DEPTH - N_A_LAYERS
HEAD_DIM = 64
N_HEADS = D_MODEL // HEAD_DIM
N_KV_HEADS = N_HEADS // 4
GROUP = N_HEADS // N_KV_HEADS
WINDOW = 128
Q_BLOCK = 128
ROPE_THETA = 500000.0
ROT_DIM = HEAD_DIM // 4
CONV_WIDTH = 3
D_FF = 2816
N_SUB = 3
EPS = 1e-6
NEG = -1e30

kernel_name = "yoco_shortconv_swa_sink_macaron_adaln_step"


def _rmsnorm(x, g):
    x32 = x.astype(jnp.float32)
    y = x32 * lax.rsqrt(jnp.mean(x32 * x32, axis=-1, keepdims=True) + EPS)
    return (y * g.astype(jnp.float32)).astype(x.dtype)


def _modulate(h, shift, scale):
    return h * (1 + scale[:, None, :]) + shift[:, None, :]


def _adaln(c, w, b, n):
    mod = jax.nn.silu(c) @ w + b
    return jnp.split(mod, n, axis=-1)


def _swiglu(h, wg, wu, wd):
    return (jax.nn.silu(h @ wg) * (h @ wu)) @ wd


def _rope(x, pos):
    half = ROT_DIM // 2
    inv_freq = ROPE_THETA ** (-jnp.arange(0, ROT_DIM, 2, dtype=jnp.float32) / ROT_DIM)
    ang = pos.astype(jnp.float32)[:, None] * inv_freq[None, :]
    cos = jnp.cos(ang)[:, None, :].astype(x.dtype)
    sin = jnp.sin(ang)[:, None, :].astype(x.dtype)
    x1 = x[..., :half]
    x2 = x[..., half:ROT_DIM]
    xp = x[..., ROT_DIM:]
    return jnp.concatenate([x1 * cos - x2 * sin, x2 * cos + x1 * sin, xp], axis=-1)


def _short_conv_mixer(h, conv_state, w_in, conv_w, w_out):
    b_g, c_g, v = jnp.split(h @ w_in, 3, axis=-1)
    u = c_g * v
    t = u.shape[1]
    padded = jnp.concatenate([conv_state.astype(u.dtype), u], axis=1)
    conv = padded[:, 0:t] * conv_w[0]
    for j in range(1, CONV_WIDTH):
        conv = conv + padded[:, j:j + t] * conv_w[j]
    y = (b_g * conv) @ w_out
    return y, padded[:, t:]


def _banded(k):
    bt, t = k.shape[:2]
    nb = t // Q_BLOCK
    pad = jnp.concatenate([jnp.zeros_like(k[:, :Q_BLOCK]), k], axis=1)
    prev = pad[:, :t].reshape(bt, nb, Q_BLOCK, N_KV_HEADS, HEAD_DIM)
    cur = k.reshape(bt, nb, Q_BLOCK, N_KV_HEADS, HEAD_DIM)
    return jnp.concatenate([prev, cur], axis=2)


def _sink_attention(q, k, v, q_pos, k_pos, sinks):
    bt, nb, qb = q.shape[:3]
    qg = q.reshape(bt, nb, qb, N_KV_HEADS, GROUP, HEAD_DIM)
    s = jnp.einsum('bnqkgd,bnskd->bnkgqs', qg, k,
                   preferred_element_type=jnp.float32) * (HEAD_DIM ** -0.5)
    rel = q_pos[:, :, None] - k_pos[:, None, :]
    mask = (rel >= 0) & (rel < WINDOW) & (k_pos[:, None, :] >= 0)
    s = jnp.where(mask[None, :, None, None], s, NEG)
    sink = sinks.astype(jnp.float32).reshape(1, 1, N_KV_HEADS, GROUP, 1, 1)
    m = jnp.maximum(jnp.max(s, axis=-1, keepdims=True), sink)
    p = jnp.exp(s - m)
    denom = jnp.sum(p, axis=-1, keepdims=True) + jnp.exp(sink - m)
    p = (p / denom).astype(v.dtype)
    o = jnp.einsum('bnkgqs,bnskd->bnqkgd', p, v)
    return o.reshape(bt, nb * qb, N_HEADS * HEAD_DIM)


def _window_attention(q, k, v, pos, k_buf, v_buf, sinks):
    bt, t = q.shape[:2]
    if k_buf is None:
        nb = t // Q_BLOCK
        qb = q.reshape(bt, nb, Q_BLOCK, N_HEADS, HEAD_DIM)
        kb = _banded(k)
        vb = _banded(v)
        q_pos = pos.reshape(nb, Q_BLOCK)
        k_pos = jnp.concatenate([q_pos - Q_BLOCK, q_pos], axis=1)
    else:
        w = k_buf.shape[1]
        qb = q[:, None]
        kb = jnp.concatenate([k_buf.astype(k.dtype), k], axis=1)[:, None]
        vb = jnp.concatenate([v_buf.astype(v.dtype), v], axis=1)[:, None]
        q_pos = pos[None]
        k_pos = jnp.concatenate([pos[0] - w + jnp.arange(w, dtype=jnp.int32), pos])[None]
    return _sink_attention(qb, kb, vb, q_pos, k_pos, sinks)


def _shared_kv(x, c, pos, p):
    sh, sc = _adaln(c, p['w_ada_kv'], p['b_ada_kv'], 2)
    h = _modulate(_rmsnorm(x, p['kv_norm_g']), sh, sc)
    bt, t = x.shape[:2]
    k = _rope((h @ p['w_k']).reshape(bt, t, N_KV_HEADS, HEAD_DIM), pos)
    v = (h @ p['w_v']).reshape(bt, t, N_KV_HEADS, HEAD_DIM)
    return k, v


def _trunk(x, c, pos, conv_states, k_buf, v_buf, p):
    bt, t = x.shape[:2]
    new_conv = []
    k = v = None
    for layer in range(DEPTH):
        if layer == N_A_LAYERS:
            k, v = _shared_kv(x, c, pos, p)
        sh1, sc1, g1, sh2, sc2, g2, sh3, sc3, g3 = _adaln(c, p['w_ada'][layer], p['b_ada'][layer], 3 * N_SUB)
        h = _modulate(_rmsnorm(x, p['norm_g'][layer, 0]), sh1, sc1)
        x = x + 0.5 * g1[:, None, :] * _swiglu(h, p['w_ffn_gate'][layer, 0], p['w_ffn_up'][layer, 0], p['w_ffn_down'][layer, 0])
        h = _modulate(_rmsnorm(x, p['norm_g'][layer, 1]), sh2, sc2)
        if layer < N_A_LAYERS:
            y, st = _short_conv_mixer(h, conv_states[layer], p['conv_w_in'][layer], p['conv_w'][layer], p['conv_w_out'][layer])
            new_conv.append(st)
        else:
            j = layer - N_A_LAYERS
            q = _rope((h @ p['attn_w_q'][j]).reshape(bt, t, N_HEADS, HEAD_DIM), pos)
            y = _window_attention(q, k, v, pos, k_buf, v_buf, p['attn_sinks'][j]) @ p['attn_w_o'][j]
        x = x + g2[:, None, :] * y
        h = _modulate(_rmsnorm(x, p['norm_g'][layer, 2]), sh3, sc3)
        x = x + 0.5 * g3[:, None, :] * _swiglu(h, p['w_ffn_gate'][layer, 1], p['w_ffn_up'][layer, 1], p['w_ffn_down'][layer, 1])
    y = _rmsnorm(x, p['final_norm_g'])
    if k_buf is None:
        k_state = k[:, -WINDOW:]
        v_state = v[:, -WINDOW:]
    else:
        w = k_buf.shape[1]
        k_state = jnp.concatenate([k_buf.astype(k.dtype), k], axis=1)[:, -w:]
        v_state = jnp.concatenate([v_buf.astype(v.dtype), v], axis=1)[:, -w:]
    return y, jnp.stack(new_conv, axis=0), k_state, v_state


def setup_inputs(seed: int = 0) -> dict:
    key = jax.random.key(seed)
    ks = jax.random.split(key, 26)
    f32 = jnp.float32
    D = D_MODEL
    w_buf = min(WINDOW, PAST_LEN)

    def nrm(k, shape, scale):
        return jax.random.normal(k, shape, f32) * scale

    return {
        'x_prompt': nrm(ks[0], (BATCH, SEQ, D), 1.0),
        'x_sample': nrm(ks[1], (DEC_BATCH, DEC_SEQ, D), 1.0),
        'state_conv': nrm(ks[2], (N_A_LAYERS, DEC_BATCH, CONV_WIDTH - 1, D), 1.0),
        'cache_k_win': nrm(ks[3], (DEC_BATCH, w_buf, N_KV_HEADS, HEAD_DIM), 1.0),
        'cache_v_win': nrm(ks[4], (DEC_BATCH, w_buf, N_KV_HEADS, HEAD_DIM), 1.0),
        'c_prompt': nrm(ks[5], (BATCH, D), 1.0),
        'c_sample': nrm(ks[6], (DEC_BATCH, D), 1.0),
        'norm_g': 1.0 + nrm(ks[7], (DEPTH, N_SUB, D), 0.02),
        'w_ada': nrm(ks[8], (DEPTH, D, 3 * N_SUB * D), 0.5 * D ** -0.5),
        'b_ada': nrm(ks[9], (DEPTH, 3 * N_SUB * D), 0.02),
        'w_ffn_gate': nrm(ks[10], (DEPTH, 2, D, D_FF), D ** -0.5),
        'w_ffn_up': nrm(ks[11], (DEPTH, 2, D, D_FF), D ** -0.5),
        'w_ffn_down': nrm(ks[12], (DEPTH, 2, D_FF, D), D_FF ** -0.5),
        'conv_w_in': nrm(ks[13], (N_A_LAYERS, D, 3 * D), D ** -0.5),
        'conv_w': nrm(ks[14], (N_A_LAYERS, CONV_WIDTH, D), CONV_WIDTH ** -0.5),
        'conv_w_out': nrm(ks[15], (N_A_LAYERS, D, D), D ** -0.5),
        'kv_norm_g': 1.0 + nrm(ks[16], (D,), 0.02),
        'w_ada_kv': nrm(ks[17], (D, 2 * D), 0.5 * D ** -0.5),
        'b_ada_kv': nrm(ks[18], (2 * D,), 0.02),
        'w_k': nrm(ks[19], (D, N_KV_HEADS * HEAD_DIM), D ** -0.5),
        'w_v': nrm(ks[20], (D, N_KV_HEADS * HEAD_DIM), D ** -0.5),
        'attn_w_q': nrm(ks[21], (N_B_LAYERS, D, N_HEADS * HEAD_DIM), D ** -0.5),
        'attn_sinks': nrm(ks[22], (N_B_LAYERS, N_HEADS), 1.0),
        'attn_w_o': nrm(ks[23], (N_B_LAYERS, N_HEADS * HEAD_DIM, D), (N_HEADS * HEAD_DIM) ** -0.5),
        'final_norm_g': 1.0 + nrm(ks[24], (D,), 0.02),
    }


def reference(x_prompt, x_sample, state_conv, cache_k_win, cache_v_win, c_prompt, c_sample,
              norm_g, w_ada, b_ada, w_ffn_gate, w_ffn_up, w_ffn_down,
              conv_w_in, conv_w, conv_w_out, kv_norm_g, w_ada_kv, b_ada_kv, w_k, w_v,
              attn_w_q, attn_sinks, attn_w_o, final_norm_g):
    p = {
        'norm_g': norm_g, 'w_ada': w_ada, 'b_ada': b_ada,
        'w_ffn_gate': w_ffn_gate, 'w_ffn_up': w_ffn_up, 'w_ffn_down': w_ffn_down,
        'conv_w_in': conv_w_in, 'conv_w': conv_w, 'conv_w_out': conv_w_out,
        'kv_norm_g': kv_norm_g, 'w_ada_kv': w_ada_kv, 'b_ada_kv': b_ada_kv,
        'w_k': w_k, 'w_v': w_v,
        'attn_w_q': attn_w_q, 'attn_sinks': attn_sinks, 'attn_w_o': attn_w_o,
        'final_norm_g': final_norm_g,
    }
    conv0 = jnp.zeros((N_A_LAYERS, x_prompt.shape[0], CONV_WIDTH - 1, D_MODEL), x_prompt.dtype)
    pos_p = jnp.arange(x_prompt.shape[1], dtype=jnp.int32)
    y_prompt, conv_p, k_p, v_p = _trunk(x_prompt, c_prompt, pos_p, conv0, None, None, p)
    pos_s = PAST_LEN + jnp.arange(x_sample.shape[1], dtype=jnp.int32)
    y_sample, conv_s, k_s, v_s = _trunk(x_sample, c_sample, pos_s, state_conv, cache_k_win, cache_v_win, p)
    return (y_prompt, y_sample, conv_p, conv_s, k_p, v_p, k_s, v_s)
```

```cpp
#include <hip/hip_runtime.h>
#include <cstdio>
#include <cstdint>

namespace pg8 {
#define PG8_LAS __attribute__((address_space(3)))
typedef unsigned short bf16_t;
typedef short bf16x8 __attribute__((ext_vector_type(8)));
typedef float f32x4 __attribute__((ext_vector_type(4)));
typedef unsigned u32x4 __attribute__((ext_vector_type(4)));
typedef unsigned u32x2 __attribute__((ext_vector_type(2)));
constexpr int BM = 256, BK = 64, HALF = 128, HTB = HALF * BK * 2, STAGE_BYTES = 8 * HTB, NXCD = 8, WGM = 8;

__host__ __device__ __forceinline__ int lds_byte(int r, int c) { const int st = (r >> 4) * 2 + (c >> 5), rr = r & 15, cc = c & 31, ob = rr * 64 + cc * 2; return st * 1024 + (ob ^ (((ob >> 9) & 1) << 5)); }
__host__ __device__ __forceinline__ void stage_rc(int b, int& R, int& C) { const int st = b / 1024, sb = b % 1024, swz = sb ^ (((sb >> 9) & 1) << 5); R = (st >> 1) * 16 + swz / 64; C = (st & 1) * 32 + (swz % 64) / 2; }
__host__ __device__ __forceinline__ int perm32(int rho) { const int n = rho >> 4, i = rho & 15; return 8 * (i >> 2) + 4 * n + (i & 3); }

struct Unit { int pm, pn; };
struct Gemm { const bf16_t* A; const bf16_t* Bt; int M, N, K, lda; };

struct StaticOrder {
    int nM, nN, nwg, G, c;
    __host__ __device__ void init(int M, int N, int G_, int c_) { nM = M / BM; nN = N / BM; nwg = nM * nN; G = G_; c = c_; }
    __host__ __device__ bool next(int i, Unit& u) const {
        const long L = (long)i * G + c; if (L >= nwg) return false;
        int wgid = (int)L; { const int q = nwg / NXCD, r = nwg % NXCD, xcd = wgid % NXCD, off = wgid / NXCD; wgid = (xcd < r ? xcd * (q + 1) : r * (q + 1) + (xcd - r) * q) + off; }
        const int nig = WGM * nN, gid = wgid / nig, fm = gid * WGM, gsz = (nM - fm) < WGM ? (nM - fm) : WGM;
        u.pm = fm + ((wgid % nig) % gsz); u.pn = (wgid % nig) / gsz; return true;
    }
    __device__ __forceinline__ void a_ready(const Unit&) const {}
    __device__ __forceinline__ void done(const Unit&) const {}
};

__device__ __forceinline__ unsigned cvt_pk_bf16(float lo, float hi) { unsigned r; asm volatile("v_cvt_pk_bf16_f32 %0, %1, %2" : "=v"(r) : "v"(lo), "v"(hi)); return r; }

template <class Epi, class Sched>
__device__ __forceinline__ void gemm_phase(PG8_LAS unsigned char* lds, const Gemm g, const Sched& S, const Epi& E) {
    int tid_ = threadIdx.x; asm volatile("" : "+v"(tid_));
    const int tid = tid_, wid = __builtin_amdgcn_readfirstlane(tid >> 6), lane = tid & 63, wr = wid >> 2, wc = wid & 3, fr = lane & 15, fq = lane >> 4;
    const int K = g.K, nt = K / BK, lda = g.lda;
    unsigned voffA[2], voffB[2];
#pragma unroll
    for (int i = 0; i < 2; ++i) { int R, C; stage_rc(tid * 16 + i * 8192, R, C); const int Rb = Epi::PERM ? ((R & ~31) + perm32(R & 31)) : R;
        voffA[i] = (unsigned)(R * lda + C) * 2u; voffB[i] = (unsigned)(Rb * K + C) * 2u; }
    constexpr unsigned kstep = BK * 2;
    const unsigned hstepA = (unsigned)HALF * lda * 2, hstepB = (unsigned)HALF * K * 2;
    const unsigned tstepA = 2 * hstepA, tstepB = 2 * hstepB;
    const unsigned ldsw = (unsigned)wid * 1024u;
    const int aoff = lds_byte(wr * 64 + fr, fq * 8), boff = lds_byte(wc * 32 + fr, fq * 8);
#define PG8_SA(b, h) (((b) * 2 + (h)) * HTB)
#define PG8_SB(b, h) ((4 + (b) * 2 + (h)) * HTB)
#define PG8_STAGE(bufoff, gbase, voff) do { _Pragma("unroll") for (int _i = 0; _i < 2; ++_i) \
        __builtin_amdgcn_global_load_lds((const unsigned*)((const char*)(gbase) + (voff)[_i]), (PG8_LAS unsigned*)(lds + (bufoff) + ldsw + _i * 8192), 16, 0, 0); } while (0)
#define PG8_LDA(dst, b, h) do { _Pragma("unroll") for (int m = 0; m < 4; ++m) _Pragma("unroll") for (int k = 0; k < 2; ++k) dst[m][k] = *(const PG8_LAS bf16x8*)(lds + PG8_SA(b, h) + aoff + m * 2048 + k * 1024); } while (0)
#define PG8_LDB(dst, b, h) do { _Pragma("unroll") for (int n = 0; n < 2; ++n) _Pragma("unroll") for (int k = 0; k < 2; ++k) dst[n][k] = *(const PG8_LAS bf16x8*)(lds + PG8_SB(b, h) + boff + n * 2048 + k * 1024); } while (0)
#define PG8_MMA(ai, bj, At, Bt) do { __builtin_amdgcn_s_setprio(1); _Pragma("unroll") for (int m = 0; m < 4; ++m) _Pragma("unroll") for (int n = 0; n < 2; ++n) _Pragma("unroll") for (int k = 0; k < 2; ++k) \
        acc[ai][bj][m][n] = __builtin_amdgcn_mfma_f32_16x16x32_bf16(Bt[n][k], At[m][k], acc[ai][bj][m][n], 0, 0, 0); __builtin_amdgcn_s_setprio(0); } while (0)
#define PG8_WAIT_V(n) asm volatile("s_waitcnt vmcnt(" #n ")" ::: "memory")
#define PG8_WAIT_L(n) asm volatile("s_waitcnt lgkmcnt(" #n ")" ::: "memory")
#define PG8_BAR __builtin_amdgcn_s_barrier()
#define PG8_SCHED __builtin_amdgcn_sched_barrier(0)
    Unit cur, nxt; int ui = 0;
    if (!S.next(0, cur)) return;
    f32x4 acc[2][2][4][2];
#pragma unroll
    for (int a = 0; a < 2; ++a)
#pragma unroll
        for (int b = 0; b < 2; ++b)
#pragma unroll
            for (int m = 0; m < 4; ++m)
#pragma unroll
                for (int n = 0; n < 2; ++n) acc[a][b][m][n] = (f32x4){0.f, 0.f, 0.f, 0.f};
    bf16x8 At[4][2], B0[2][2], B1[2][2];
    const char* cA = (const char*)g.A + (size_t)cur.pm * tstepA; const char* cB = (const char*)g.Bt + (size_t)cur.pn * tstepB;
    S.a_ready(cur);
    PG8_STAGE(PG8_SB(0, 0), cB, voffB); PG8_STAGE(PG8_SB(0, 1), cB + hstepB, voffB); PG8_STAGE(PG8_SA(0, 0), cA, voffA); PG8_STAGE(PG8_SA(0, 1), cA + hstepA, voffA);
    if (wr == 1) PG8_BAR;
    PG8_WAIT_V(2); PG8_BAR;
    PG8_STAGE(PG8_SB(1, 0), cB + kstep, voffB); PG8_STAGE(PG8_SA(1, 0), cA + kstep, voffA); PG8_STAGE(PG8_SB(1, 1), cB + hstepB + kstep, voffB);
    PG8_WAIT_V(6); PG8_BAR;
    for (;;) {
        const bool has_next = S.next(ui + 1, nxt);
        const char* nA = has_next ? (const char*)g.A + (size_t)nxt.pm * tstepA : cA; const char* nB = has_next ? (const char*)g.Bt + (size_t)nxt.pn * tstepB : cB;
        for (int t = 0; t < nt; t += 2) {
            const bool last = (t == nt - 2);
            const char* a1 = cA + (size_t)(t + 1) * kstep;
            const char* a2 = last ? nA : cA + (size_t)(t + 2) * kstep; const char* b2 = last ? nB : cB + (size_t)(t + 2) * kstep;
            const char* a3 = a2 + kstep; const char* b3 = b2 + kstep;
            if (last && has_next) S.a_ready(nxt);
            PG8_LDB(B0, 0, 0); PG8_LDB(B1, 0, 1); PG8_SCHED; PG8_LDA(At, 0, 0); PG8_STAGE(PG8_SA(1, 1), a1 + hstepA, voffA);
            PG8_WAIT_V(8); PG8_WAIT_L(0); PG8_BAR; PG8_MMA(0, 0, At, B0); PG8_MMA(0, 1, At, B1); PG8_BAR; PG8_SCHED;
            PG8_LDA(At, 0, 1); PG8_STAGE(PG8_SB(0, 0), b2, voffB); PG8_STAGE(PG8_SB(0, 1), b2 + hstepB, voffB); PG8_STAGE(PG8_SA(0, 0), a2, voffA);
            PG8_WAIT_V(8); PG8_WAIT_L(0); PG8_BAR; PG8_MMA(1, 0, At, B0); PG8_MMA(1, 1, At, B1); PG8_BAR; PG8_SCHED;
            PG8_LDB(B0, 1, 0); PG8_LDB(B1, 1, 1); PG8_SCHED; PG8_LDA(At, 1, 0); PG8_STAGE(PG8_SA(0, 1), a2 + hstepA, voffA);
            PG8_WAIT_V(8); PG8_WAIT_L(0); PG8_BAR; PG8_MMA(0, 0, At, B0); PG8_MMA(0, 1, At, B1); PG8_BAR; PG8_SCHED;
            PG8_LDA(At, 1, 1); PG8_STAGE(PG8_SB(1, 0), b3, voffB); PG8_STAGE(PG8_SB(1, 1), b3 + hstepB, voffB); PG8_STAGE(PG8_SA(1, 0), a3, voffA);
            PG8_WAIT_V(8); PG8_WAIT_L(0); PG8_BAR; PG8_MMA(1, 0, At, B0); PG8_MMA(1, 1, At, B1); PG8_BAR; PG8_SCHED;
        }
        if (wr == 0) PG8_BAR;
        E(acc, cur, wr, wc, fr, fq); S.done(cur);
        if (!has_next) break;
#pragma unroll
        for (int a = 0; a < 2; ++a)
#pragma unroll
            for (int b = 0; b < 2; ++b)
#pragma unroll
                for (int m = 0; m < 4; ++m)
#pragma unroll
                    for (int n = 0; n < 2; ++n) acc[a][b][m][n] = (f32x4){0.f, 0.f, 0.f, 0.f};
        cur = nxt; cA = nA; cB = nB; ++ui;
        if (wr == 1) PG8_BAR;
    }
    PG8_WAIT_V(0);
    PG8_BAR;
#undef PG8_SA
#undef PG8_SB
#undef PG8_STAGE
#undef PG8_LDA
#undef PG8_LDB
#undef PG8_MMA
#undef PG8_WAIT_V
#undef PG8_WAIT_L
#undef PG8_BAR
#undef PG8_SCHED
}
}

using pg8::bf16_t; using pg8::f32x4; using pg8::u32x4; using pg8::u32x2; using pg8::bf16x8; using pg8::Unit; using pg8::cvt_pk_bf16;
#define GAS __attribute__((address_space(1)))
#define LAS __attribute__((address_space(3)))
typedef float f32x16 __attribute__((ext_vector_type(16)));

constexpr int MP = 16384, MS = 1024, MT = MP + MS;
constexpr int D = 1024, FF = 2816, NSEQ = 130, SEQ = 8192, PAST = 16384;
constexpr int MODW = 20480;
constexpr int BWW = 27136;
constexpr float EPS = 1e-6f;
constexpr float QSCALE = 0.125f * 1.4426950408889634f;
constexpr float LOG2E = 1.4426950408889634f;

constexpr size_t MiB = 1u << 20;
constexpr size_t WS_CTL = 0, CTL_ZERO_BYTES = 64 * 1024;
constexpr size_t WS_WUP = 1 * MiB;
constexpr size_t WS_WDN = 45 * MiB;
constexpr size_t WS_WIN = 67 * MiB;
constexpr size_t WS_WOUT = 73 * MiB, WS_WQ = 75 * MiB, WS_WO = 77 * MiB, WS_WKV = 79 * MiB;
constexpr size_t WS_WADA = 80 * MiB;
constexpr size_t WS_BIASW = 80 * MiB;
constexpr size_t WS_KB = 94 * MiB;
constexpr size_t WS_VB = 94 * MiB + 8912896;
constexpr size_t WS_SSQ = 111 * MiB;
constexpr size_t SSQ_BYTES = (size_t)MT * 16 * 4;
constexpr size_t WS_MODSF = 120 * MiB;
constexpr size_t WS_MODSB = 131 * MiB;
constexpr size_t WS_AC = 141 * MiB;
constexpr size_t WS_ROPE = 141 * MiB + 512 * 1024;
constexpr size_t WS_AP = 143 * MiB, WS_AQ = 177 * MiB;
constexpr size_t WS_ACT = 211 * MiB;
constexpr size_t WS_U = WS_ACT, WS_Z = WS_ACT + 34 * MiB, WS_QB = WS_ACT, WS_AO = WS_ACT + 34 * MiB;
constexpr size_t WS_END = 305 * MiB;
static_assert(WS_VB + 8912896 <= WS_SSQ && WS_SSQ + 7 * SSQ_BYTES <= WS_MODSF && WS_ROPE + (size_t)MT * 64 <= WS_AP && WS_ACT + (size_t)MT * FF * 2 <= WS_END, "ws map");
constexpr int CW_BAR = 1024;

constexpr size_t O_Y = 0, O_CONVP = (size_t)MT * D, O_CONVS = O_CONVP + 4096, O_KP = O_CONVS + 262144, O_VP = O_KP + 65536, O_KS = O_VP + 65536, O_VS = O_KS + 4194304;

constexpr int RING_BYTES = 131072, MISC_OFF = RING_BYTES + 320, LDS_BYTES = 147456;

typedef GAS unsigned gu32;
__device__ __forceinline__ int seq_of_row(int row) { return row < MP ? (row >> 13) : 2 + ((row - MP) >> 3); }
__device__ __forceinline__ float row_rstd(const float* ssq, int row) {
    const f32x4* p = (const f32x4*)(ssq + (size_t)row * 16);
    const f32x4 a = p[0], b = p[1], c = p[2], d = p[3];
    const float s = ((a[0] + a[1]) + (a[2] + a[3])) + ((b[0] + b[1]) + (b[2] + b[3])) + ((c[0] + c[1]) + (c[2] + c[3])) + ((d[0] + d[1]) + (d[2] + d[3]));
    return 1.0f / sqrtf(s * (1.0f / 1024.0f) + EPS);
}
__device__ __forceinline__ float silu_f(float x) { return x * __builtin_amdgcn_rcpf(1.0f + __builtin_amdgcn_exp2f(-x * LOG2E)); }
__device__ __forceinline__ float bf2f(unsigned short b) { return __uint_as_float((unsigned)b << 16); }
__device__ __forceinline__ float bflo(unsigned w) { return __uint_as_float(w << 16); }
__device__ __forceinline__ float bfhi(unsigned w) { return __uint_as_float(w & 0xffff0000u); }

#define XB_TMO      128
#define XB_XCNT(j)  (256  + 64 * (j))
#define XB_XSUB(j)  (1280 + 64 * (j))
#define XB_XGEN(j)  (2304 + 64 * (j))
#define XB_TOP      3328
#define XB_TOPGEN   3392
#define XCD_BAR_WORDS 3456
#define XB_SPIN_CAP (1u << 20)
__device__ __forceinline__ unsigned xb_ld(unsigned* p)              { return __hip_atomic_load(p, __ATOMIC_RELAXED, __HIP_MEMORY_SCOPE_AGENT); }
__device__ __forceinline__ unsigned xb_add(unsigned* p, unsigned v) { return __hip_atomic_fetch_add(p, v, __ATOMIC_RELAXED, __HIP_MEMORY_SCOPE_AGENT); }
__device__ __forceinline__ unsigned xb_xcc_id() { return (unsigned)__builtin_amdgcn_s_getreg((3 << 11) | 20) & 0xFu; }
#define XB_SPIN(cond, bar) do { unsigned _sp = 0; while (cond) { __builtin_amdgcn_s_sleep(1); \
    if ((++_sp & 255u) == 0u) { if (xb_ld(&(bar)[XB_TMO])) break; if (_sp > XB_SPIN_CAP) { atomicAdd(&(bar)[XB_TMO], 1u); break; } } } } while (0)
struct XcdBarrier { unsigned* bar; unsigned x; volatile LAS unsigned* st; };
__device__ __forceinline__ XcdBarrier xcd_barrier_post(unsigned* bar, volatile LAS unsigned* st) {
    XcdBarrier b; b.bar = bar; b.x = xb_xcc_id(); b.st = st;
    if (threadIdx.x == 0) (void)xb_add(&bar[XB_XCNT(b.x)], 1u);
    return b;
}
__device__ __forceinline__ void xcd_barrier_complete(unsigned* bar, unsigned x, unsigned& nloc, unsigned& nx) {
    const unsigned G = gridDim.x * gridDim.y * gridDim.z;
    unsigned sum, cnt, mine, sp = 0u;
    for (;;) {
        sum = 0u; cnt = 0u; mine = 0u;
#pragma unroll
        for (unsigned j = 0; j < 16; ++j) { const unsigned c = xb_ld(&bar[XB_XCNT(j)]); sum += c; cnt += (c > 0u) ? 1u : 0u; mine = (j == x) ? c : mine; }
        if (sum == G) break;
        __builtin_amdgcn_s_sleep(1);
        if ((++sp & 255u) == 0u) { if (xb_ld(&bar[XB_TMO])) break; if (sp > XB_SPIN_CAP) { atomicAdd(&bar[XB_TMO], 1u); break; } }
    }
    nloc = mine > 0u ? mine : 1u; nx = cnt > 0u ? cnt : 1u;
}
__device__ __forceinline__ void xcd_barrier(const XcdBarrier& b) {
    asm volatile("s_waitcnt vmcnt(0)" ::: "memory");
    __syncthreads();
    if (threadIdx.x == 0) {
        unsigned* bar = b.bar; unsigned bx_ = b.x;
        asm volatile("" : "+s"(bar), "+s"(bx_));
        __builtin_amdgcn_s_waitcnt(0);
        unsigned nloc = b.st[0], nx = b.st[1];
        if (nloc == 0u) { xcd_barrier_complete(bar, bx_, nloc, nx); b.st[0] = nloc; b.st[1] = nx; }
        const unsigned old = xb_add(&bar[XB_XSUB(bx_)], 1u);
        const unsigned gen = old / nloc;
        if (old + 1u == (gen + 1u) * nloc) {
            __builtin_amdgcn_fence(__ATOMIC_RELEASE, "agent");
            asm volatile("s_waitcnt vmcnt(0)" ::: "memory");
            const unsigned og = xb_add(&bar[XB_TOP], 1u);
            const unsigned tg = og / nx;
            if (og + 1u == (tg + 1u) * nx) xb_add(&bar[XB_TOPGEN], 1u);
            else XB_SPIN(xb_ld(&bar[XB_TOPGEN]) == tg, bar);
            __builtin_amdgcn_fence(__ATOMIC_ACQUIRE, "agent");
            xb_add(&bar[XB_XGEN(bx_)], 1u);
            asm volatile("s_waitcnt vmcnt(0)" ::: "memory");
        } else {
            XB_SPIN(xb_ld(&bar[XB_XGEN(bx_)]) == gen, bar);
            __builtin_amdgcn_fence(__ATOMIC_ACQUIRE, "agent");
            asm volatile("s_waitcnt vmcnt(0)" ::: "memory");
        }
    }
    __syncthreads();
}

struct Args { const float* in[25]; float* out; unsigned char* ws; };
typedef const __attribute__((address_space(4))) Args* KArgP;
#define EPI_ARGS() KArgP p = ap; asm volatile("" : "+s"(p)); unsigned char* const w_ = p->ws; (void)w_
struct EpiAda {
    static constexpr bool PERM = false;
    KArgP ap;
    __device__ __forceinline__ void operator()(const f32x4 (&acc)[2][2][4][2], const Unit& u, int wr, int wc, int fr, int fq) const {
        EPI_ARGS(); float* mf = (float*)(w_ + WS_MODSF); bf16_t* mb = (bf16_t*)(w_ + WS_MODSB); const float* b_ada = p->in[9]; const float* b_kv = p->in[18];
        const int col0 = u.pn * 256 + wc * 32 + 4 * fq;
        const float* bias = (u.pn < 72) ? b_ada : (b_kv - 18432);
#pragma unroll
        for (int ai = 0; ai < 2; ++ai)
#pragma unroll
            for (int m = 0; m < 4; ++m) {
                const int row = ai * 128 + wr * 64 + m * 16 + fr;
                if (row < NSEQ) {
#pragma unroll
                    for (int bj = 0; bj < 2; ++bj)
#pragma unroll
                        for (int n = 0; n < 2; ++n) { const int col = col0 + bj * 128 + n * 16;
                            const f32x4 v = acc[ai][bj][m][n] + *(const f32x4*)(bias + col);
                            *(f32x4*)(mf + (size_t)row * MODW + col) = v;
                            u32x2 w; w.x = cvt_pk_bf16(v[0], v[1]); w.y = cvt_pk_bf16(v[2], v[3]);
                            *(u32x2*)(mb + (size_t)row * MODW + col) = w; }
                }
            }
    }
};
struct EpiBw {
    static constexpr bool PERM = false;
    KArgP ap; int bwoff;
    __device__ __forceinline__ void operator()(const f32x4 (&acc)[2][2][4][2], const Unit& u, int wr, int wc, int fr, int fq) const {
        EPI_ARGS(); float* out = (float*)(w_ + WS_BIASW) + bwoff;
        const int col0 = u.pn * 256 + wc * 32 + 4 * fq;
#pragma unroll
        for (int ai = 0; ai < 2; ++ai)
#pragma unroll
            for (int m = 0; m < 4; ++m) {
                const int row = ai * 128 + wr * 64 + m * 16 + fr;
                if (row < NSEQ) {
#pragma unroll
                    for (int bj = 0; bj < 2; ++bj)
#pragma unroll
                        for (int n = 0; n < 2; ++n) *(f32x4*)(out + (size_t)row * BWW + col0 + bj * 128 + n * 16) = acc[ai][bj][m][n];
                }
            }
    }
};
struct EpiUp {
    static constexpr bool PERM = true;
    KArgP ap; int sq, bwoff;
    __device__ __forceinline__ void operator()(const f32x4 (&acc)[2][2][4][2], const Unit& u, int wr, int wc, int fr, int fq) const {
        EPI_ARGS(); const float* ssq = (const float*)(w_ + WS_SSQ + (size_t)sq * SSQ_BYTES); const float* bw = (const float*)(w_ + WS_BIASW) + bwoff; bf16_t* act = (bf16_t*)(w_ + WS_ACT);
        const int row0 = u.pm * 256 + wr * 64 + fr, colg = u.pn * 256 + wc * 32 + 8 * fq, acol = u.pn * 128 + wc * 32 + 8 * fq;
#pragma unroll
        for (int ai = 0; ai < 2; ++ai)
#pragma unroll
            for (int m = 0; m < 4; ++m) {
                const int row = row0 + ai * 128 + m * 16;
                const float rs = row_rstd(ssq, row);
                const float* b = bw + (size_t)seq_of_row(row) * BWW + colg;
                const f32x4 g0 = acc[ai][0][m][0] * rs + *(const f32x4*)(b), g1 = acc[ai][0][m][1] * rs + *(const f32x4*)(b + 4);
                const f32x4 u0 = acc[ai][1][m][0] * rs + *(const f32x4*)(b + 128), u1 = acc[ai][1][m][1] * rs + *(const f32x4*)(b + 132);
                u32x4 w;
                w.x = cvt_pk_bf16(silu_f(g0[0]) * u0[0], silu_f(g0[1]) * u0[1]); w.y = cvt_pk_bf16(silu_f(g0[2]) * u0[2], silu_f(g0[3]) * u0[3]);
                w.z = cvt_pk_bf16(silu_f(g1[0]) * u1[0], silu_f(g1[1]) * u1[1]); w.w = cvt_pk_bf16(silu_f(g1[2]) * u1[2], silu_f(g1[3]) * u1[3]);
                *(u32x4*)(act + (size_t)row * FF + acol) = w;
            }
    }
};
struct EpiRes {
    static constexpr bool PERM = false;
    KArgP ap; int step;
    __device__ __forceinline__ void operator()(const f32x4 (&acc)[2][2][4][2], const Unit& u, int wr, int wc, int fr, int fq) const {
        EPI_ARGS();
        const float* xin_p = nullptr; const float* xin_s = nullptr;
        float* xio = p->out + O_Y; const float* mods = (const float*)(w_ + WS_MODSF); const float* ng = p->in[7];
        bf16_t* const AP_ = (bf16_t*)(w_ + WS_AP); bf16_t* const AQ_ = (bf16_t*)(w_ + WS_AQ);
        int gate_off, sc1_off = 0, sc2_off = 0, sqi; float gs = 0.5f; bf16_t* ap1 = nullptr; bf16_t* ap2 = nullptr; const float* gn1 = nullptr; const float* gn2 = nullptr;
        if (step == 1)       { xin_p = p->in[0]; xin_s = p->in[1]; gate_off = 2048; ap1 = AQ_; gn1 = ng + 1 * D; sc1_off = 4096; sqi = 1; }
        else if (step == 4)  { gate_off = 5120; gs = 1.0f; ap1 = AP_; gn1 = ng + 2 * D; sc1_off = 7168; sqi = 2; }
        else if (step == 6)  { gate_off = 8192; ap1 = AQ_; gn1 = ng + 3 * D; sc1_off = 9216 + 1024; ap2 = AP_; gn2 = p->in[16]; sc2_off = 19456; sqi = 3; }
        else if (step == 8)  { gate_off = 9216 + 2048; ap1 = AP_; gn1 = ng + 4 * D; sc1_off = 9216 + 4096; sqi = 4; }
        else if (step == 11) { gate_off = 9216 + 5120; gs = 1.0f; ap1 = AQ_; gn1 = ng + 5 * D; sc1_off = 9216 + 7168; sqi = 5; }
        else                 { gate_off = 9216 + 8192; sqi = 6; }
        float* ssq_out = (float*)(w_ + WS_SSQ + (size_t)sqi * SSQ_BYTES);
        const int row0 = u.pm * 256 + wr * 64 + fr, col0 = u.pn * 256 + wc * 32 + 4 * fq;
#pragma unroll
        for (int ai = 0; ai < 2; ++ai)
#pragma unroll
            for (int m = 0; m < 4; ++m) {
                const int row = row0 + ai * 128 + m * 16;
                const float* md = mods + (size_t)seq_of_row(row) * MODW;
                const float* xo = xin_p ? (row < MP ? xin_p + (size_t)row * D : xin_s + (size_t)(row - MP) * D) : xio + (size_t)row * D;
                float ss = 0.f;
#pragma unroll
                for (int bj = 0; bj < 2; ++bj)
#pragma unroll
                    for (int n = 0; n < 2; ++n) { const int col = col0 + bj * 128 + n * 16;
                        const f32x4 gt = *(const f32x4*)(md + gate_off + col);
                        const f32x4 xn = *(const f32x4*)(xo + col) + (acc[ai][bj][m][n] * gs) * gt;
                        *(f32x4*)(xio + (size_t)row * D + col) = xn;
                        ss += (xn[0] * xn[0] + xn[1] * xn[1]) + (xn[2] * xn[2] + xn[3] * xn[3]);
                        if (ap1) { const f32x4 a = xn * (*(const f32x4*)(gn1 + col)) * (*(const f32x4*)(md + sc1_off + col) + 1.0f);
                            u32x2 w; w.x = cvt_pk_bf16(a[0], a[1]); w.y = cvt_pk_bf16(a[2], a[3]); *(u32x2*)(ap1 + (size_t)row * D + col) = w; }
                        if (ap2) { const f32x4 a = xn * (*(const f32x4*)(gn2 + col)) * (*(const f32x4*)(md + sc2_off + col) + 1.0f);
                            u32x2 w; w.x = cvt_pk_bf16(a[0], a[1]); w.y = cvt_pk_bf16(a[2], a[3]); *(u32x2*)(ap2 + (size_t)row * D + col) = w; }
                    }
                ss += __shfl_xor(ss, 16); ss += __shfl_xor(ss, 32);
                if (fq == 0) ssq_out[(size_t)row * 16 + u.pn * 4 + wc] = ss;
            }
    }
};
struct EpiU {
    static constexpr bool PERM = true;
    KArgP ap;
    __device__ __forceinline__ void operator()(const f32x4 (&acc)[2][2][4][2], const Unit& u, int wr, int wc, int fr, int fq) const {
        EPI_ARGS(); const float* ssq = (const float*)(w_ + WS_SSQ + 1 * SSQ_BYTES); const float* bw = (const float*)(w_ + WS_BIASW) + 5632; bf16_t* U = (bf16_t*)(w_ + WS_U);
        float* convp = p->out + O_CONVP; float* convs = p->out + O_CONVS;
        const int row0 = u.pm * 256 + wr * 64 + fr, colg = u.pn * 256 + wc * 32 + 8 * fq, ucol = u.pn * 128 + wc * 32 + 8 * fq;
#pragma unroll
        for (int ai = 0; ai < 2; ++ai)
#pragma unroll
            for (int m = 0; m < 4; ++m) {
                const int row = row0 + ai * 128 + m * 16;
                const float rs = row_rstd(ssq, row);
                const float* b = bw + (size_t)seq_of_row(row) * BWW + colg;
                const f32x4 c0 = acc[ai][0][m][0] * rs + *(const f32x4*)(b), c1 = acc[ai][0][m][1] * rs + *(const f32x4*)(b + 4);
                const f32x4 v0 = acc[ai][1][m][0] * rs + *(const f32x4*)(b + 128), v1 = acc[ai][1][m][1] * rs + *(const f32x4*)(b + 132);
                const f32x4 p0 = c0 * v0, p1 = c1 * v1;
                u32x4 w; w.x = cvt_pk_bf16(p0[0], p0[1]); w.y = cvt_pk_bf16(p0[2], p0[3]); w.z = cvt_pk_bf16(p1[0], p1[1]); w.w = cvt_pk_bf16(p1[2], p1[3]);
                *(u32x4*)(U + (size_t)row * D + ucol) = w;
                float* dst = nullptr;
                if (row < MP) { const int t = row & (SEQ - 1); if (t >= SEQ - 2) dst = convp + ((size_t)((row >> 13) * 2 + (t - (SEQ - 2)))) * D + ucol; }
                else { const int t = row & 7; if (t >= 6) dst = convs + ((size_t)(((row - MP) >> 3) * 2 + (t - 6))) * D + ucol; }
                if (dst) { *(f32x4*)dst = p0; *(f32x4*)(dst + 4) = p1; }
            }
    }
};
struct EpiBg {
    static constexpr bool PERM = true;
    KArgP ap;
    __device__ __forceinline__ void operator()(const f32x4 (&acc)[2][2][4][2], const Unit& u, int wr, int wc, int fr, int fq) const {
        EPI_ARGS(); const float* ssq = (const float*)(w_ + WS_SSQ + 1 * SSQ_BYTES); const float* bw = (const float*)(w_ + WS_BIASW) + 5632 + 2048; const bf16_t* U = (const bf16_t*)(w_ + WS_U);
        bf16_t* Z = (bf16_t*)(w_ + WS_Z); const float* convw = p->in[14]; const float* state = p->in[2];
        const int row0 = u.pm * 256 + wr * 64 + fr;
#pragma unroll
        for (int bj = 0; bj < 2; ++bj) {
            const int col = u.pn * 256 + bj * 128 + wc * 32 + 8 * fq;
            const f32x4 w0a = *(const f32x4*)(convw + col), w0b = *(const f32x4*)(convw + col + 4);
            const f32x4 w1a = *(const f32x4*)(convw + D + col), w1b = *(const f32x4*)(convw + D + col + 4);
            const f32x4 w2a = *(const f32x4*)(convw + 2 * D + col), w2b = *(const f32x4*)(convw + 2 * D + col + 4);
#pragma unroll
            for (int ai = 0; ai < 2; ++ai)
#pragma unroll
                for (int m = 0; m < 4; ++m) {
                    const int row = row0 + ai * 128 + m * 16;
                    const float rs = row_rstd(ssq, row);
                    const float* b = bw + (size_t)seq_of_row(row) * BWW + col;
                    const f32x4 g0 = acc[ai][bj][m][0] * rs + *(const f32x4*)(b), g1 = acc[ai][bj][m][1] * rs + *(const f32x4*)(b + 4);
                    const bool smp = row >= MP; const int t = smp ? (row & 7) : (row & (SEQ - 1));
                    const u32x4 uc = *(const u32x4*)(U + (size_t)row * D + col);
                    f32x4 a1 = {0.f, 0.f, 0.f, 0.f}, b1 = a1, a2 = a1, b2 = a1;
                    if (t >= 1) { const u32x4 q = *(const u32x4*)(U + (size_t)(row - 1) * D + col);
                        a1 = (f32x4){bflo(q.x), bfhi(q.x), bflo(q.y), bfhi(q.y)}; b1 = (f32x4){bflo(q.z), bfhi(q.z), bflo(q.w), bfhi(q.w)}; }
                    else if (smp) { const float* sp = state + ((size_t)((row - MP) >> 3) * 2 + 1) * D + col; a1 = *(const f32x4*)sp; b1 = *(const f32x4*)(sp + 4); }
                    if (t >= 2) { const u32x4 q = *(const u32x4*)(U + (size_t)(row - 2) * D + col);
                        a2 = (f32x4){bflo(q.x), bfhi(q.x), bflo(q.y), bfhi(q.y)}; b2 = (f32x4){bflo(q.z), bfhi(q.z), bflo(q.w), bfhi(q.w)}; }
                    else if (smp) { const float* sp = state + ((size_t)((row - MP) >> 3) * 2 + t) * D + col; a2 = *(const f32x4*)sp; b2 = *(const f32x4*)(sp + 4); }
                    const f32x4 a0 = (f32x4){bflo(uc.x), bfhi(uc.x), bflo(uc.y), bfhi(uc.y)}, b0 = (f32x4){bflo(uc.z), bfhi(uc.z), bflo(uc.w), bfhi(uc.w)};
                    const f32x4 za = g0 * (a2 * w0a + a1 * w1a + a0 * w2a), zb = g1 * (b2 * w0b + b1 * w1b + b0 * w2b);
                    u32x4 w; w.x = cvt_pk_bf16(za[0], za[1]); w.y = cvt_pk_bf16(za[2], za[3]); w.z = cvt_pk_bf16(zb[0], zb[1]); w.w = cvt_pk_bf16(zb[2], zb[3]);
                    *(u32x4*)(Z + (size_t)row * D + col) = w;
                }
        }
    }
};
__device__ __forceinline__ void rope8(f32x4& v0, f32x4& v1, const float* tab, bool active, int fq) {
    f32x4 p0, p1;
#pragma unroll
    for (int j = 0; j < 4; ++j) { p0[j] = __shfl_xor(v0[j], 16); p1[j] = __shfl_xor(v1[j], 16); }
    if (active) {
        const f32x4 c0 = *(const f32x4*)(tab), c1 = *(const f32x4*)(tab + 4), s0 = *(const f32x4*)(tab + 8), s1 = *(const f32x4*)(tab + 12);
        const float sg = (fq == 0) ? -1.0f : 1.0f;
        v0 = v0 * c0 + (p0 * sg) * s0; v1 = v1 * c1 + (p1 * sg) * s1;
    }
}
struct EpiKV {
    static constexpr bool PERM = true;
    KArgP ap;
    __device__ __forceinline__ void operator()(const f32x4 (&acc)[2][2][4][2], const Unit& u, int wr, int wc, int fr, int fq) const {
        EPI_ARGS(); const float* ssq = (const float*)(w_ + WS_SSQ + 3 * SSQ_BYTES); const float* bw = (const float*)(w_ + WS_BIASW) + 14336; const float* rope = (const float*)(w_ + WS_ROPE);
        bf16_t* KB = (bf16_t*)(w_ + WS_KB); bf16_t* VB = (bf16_t*)(w_ + WS_VB); float* kp = p->out + O_KP; float* vp = p->out + O_VP; float* ks = p->out + O_KS; float* vs = p->out + O_VS;
        const int row0 = u.pm * 256 + wr * 64 + fr;
        const bool isk = (u.pn == 0);
        bf16_t* ob = isk ? KB : VB; float* op = isk ? kp : vp; float* os = isk ? ks : vs;
#pragma unroll
        for (int ai = 0; ai < 2; ++ai)
#pragma unroll
            for (int m = 0; m < 4; ++m) {
                const int row = row0 + ai * 128 + m * 16;
                const float rs = row_rstd(ssq, row);
                const float* b = bw + (size_t)seq_of_row(row) * BWW + u.pn * 256 + wc * 32 + 8 * fq;
                float* dst = nullptr;
                if (row < MP) { const int t = row & (SEQ - 1); if (t >= SEQ - 128) dst = op + ((size_t)((row >> 13) * 128 + (t - (SEQ - 128)))) * 256; }
                else { dst = os + ((size_t)(((row - MP) >> 3) * 128 + 120 + (row & 7))) * 256; }
#pragma unroll
                for (int bj = 0; bj < 2; ++bj) {
                    const int col = bj * 128 + wc * 32 + 8 * fq;
                    f32x4 v0 = acc[ai][bj][m][0] * rs + *(const f32x4*)(b + bj * 128), v1 = acc[ai][bj][m][1] * rs + *(const f32x4*)(b + bj * 128 + 4);
                    if (isk && (wc & 1) == 0) rope8(v0, v1, rope + (size_t)row * 16, fq < 2, fq);
                    u32x4 w; w.x = cvt_pk_bf16(v0[0], v0[1]); w.y = cvt_pk_bf16(v0[2], v0[3]); w.z = cvt_pk_bf16(v1[0], v1[1]); w.w = cvt_pk_bf16(v1[2], v1[3]);
                    *(u32x4*)(ob + (size_t)row * 256 + col) = w;
                    if (dst) { *(f32x4*)(dst + col) = v0; *(f32x4*)(dst + col + 4) = v1; }
                }
            }
    }
};
struct EpiQ {
    static constexpr bool PERM = true;
    KArgP ap;
    __device__ __forceinline__ void operator()(const f32x4 (&acc)[2][2][4][2], const Unit& u, int wr, int wc, int fr, int fq) const {
        EPI_ARGS(); const float* ssq = (const float*)(w_ + WS_SSQ + 4 * SSQ_BYTES); const float* bw = (const float*)(w_ + WS_BIASW) + 20480; const float* rope = (const float*)(w_ + WS_ROPE); bf16_t* QB = (bf16_t*)(w_ + WS_QB);
        const int row0 = u.pm * 256 + wr * 64 + fr;
#pragma unroll
        for (int ai = 0; ai < 2; ++ai)
#pragma unroll
            for (int m = 0; m < 4; ++m) {
                const int row = row0 + ai * 128 + m * 16;
                const float rs = row_rstd(ssq, row);
                const float* b = bw + (size_t)seq_of_row(row) * BWW + u.pn * 256 + wc * 32 + 8 * fq;
#pragma unroll
                for (int bj = 0; bj < 2; ++bj) {
                    const int col = u.pn * 256 + bj * 128 + wc * 32 + 8 * fq;
                    f32x4 v0 = acc[ai][bj][m][0] * rs + *(const f32x4*)(b + bj * 128), v1 = acc[ai][bj][m][1] * rs + *(const f32x4*)(b + bj * 128 + 4);
                    if ((wc & 1) == 0) rope8(v0, v1, rope + (size_t)row * 16, fq < 2, fq);
                    v0 = v0 * QSCALE; v1 = v1 * QSCALE;
                    u32x4 w; w.x = cvt_pk_bf16(v0[0], v0[1]); w.y = cvt_pk_bf16(v0[2], v0[3]); w.z = cvt_pk_bf16(v1[0], v1[1]); w.w = cvt_pk_bf16(v1[2], v1[3]);
                    *(u32x4*)(QB + (size_t)row * D + col) = w;
                }
            }
    }
};

__device__ __forceinline__ int crow(int r, int hi) { return (r & 3) + 8 * (r >> 2) + 4 * hi; }
__device__ __forceinline__ void attn_softmax(f32x16 (&S)[5], int kmin, int kmax, float sink2, int hi) {
    float mx = sink2;
#pragma unroll
    for (int kt = 0; kt < 5; ++kt)
#pragma unroll
        for (int r = 0; r < 16; ++r) { const int kk = 32 * kt + crow(r, hi); const float s = (kk >= kmin && kk <= kmax) ? S[kt][r] : -1e30f; S[kt][r] = s; mx = fmaxf(mx, s); }
    mx = fmaxf(mx, __shfl_xor(mx, 32));
    float sum = 0.f;
#pragma unroll
    for (int kt = 0; kt < 5; ++kt)
#pragma unroll
        for (int r = 0; r < 16; ++r) { const float p = __builtin_amdgcn_exp2f(S[kt][r] - mx); S[kt][r] = p; sum += p; }
    sum += __shfl_xor(sum, 32);
    sum += __builtin_amdgcn_exp2f(sink2 - mx);
    const float inv = 1.0f / sum;
#pragma unroll
    for (int kt = 0; kt < 5; ++kt)
#pragma unroll
        for (int r = 0; r < 16; ++r) S[kt][r] *= inv;
}
__device__ __forceinline__ bf16x8 pfrag(const f32x16& P, int s2) {
    u32x4 w; w.x = cvt_pk_bf16(P[8 * s2 + 0], P[8 * s2 + 1]); w.y = cvt_pk_bf16(P[8 * s2 + 2], P[8 * s2 + 3]); w.z = cvt_pk_bf16(P[8 * s2 + 4], P[8 * s2 + 5]); w.w = cvt_pk_bf16(P[8 * s2 + 6], P[8 * s2 + 7]);
    return __builtin_bit_cast(bf16x8, w);
}
constexpr int AK_PITCH = 144, AV_PITCH = 392, AK_BYTES = 192 * AK_PITCH, AV_OFF = AK_BYTES, AV_BYTES = 64 * AV_PITCH;
static_assert(AV_OFF + AV_BYTES <= RING_BYTES && (AK_BYTES % 16) == 0, "attention LDS");

__device__ __forceinline__ void attn_prompt_unit(LAS unsigned char* lds, int unit, const bf16_t* QB, const bf16_t* KB, const bf16_t* VB, const float* sinks, bf16_t* AO) {
    int tid_ = threadIdx.x; asm volatile("" : "+v"(tid_));
    const int tid = tid_, lane = tid & 63, r = lane & 31, hi = lane >> 5, wid = __builtin_amdgcn_readfirstlane(tid >> 6);
    const int kvh = unit & 3, blk = unit >> 2, R0 = blk * 64, tb = R0 & (SEQ - 1);
#pragma unroll
    for (int j = 0; j < 3; ++j) {
        const int c = tid + 512 * j, key = c >> 3, part = c & 7;
        u32x4 kv = {0u, 0u, 0u, 0u}, vv = {0u, 0u, 0u, 0u};
        if (tb - 128 + key >= 0) { const size_t g = (size_t)(R0 - 128 + key) * 256 + kvh * 64 + part * 8; kv = *(const u32x4*)(KB + g); vv = *(const u32x4*)(VB + g); }
        *(LAS u32x4*)(lds + key * AK_PITCH + part * 16) = kv;
        LAS unsigned short* vt = (LAS unsigned short*)(lds + AV_OFF + (part * 8) * AV_PITCH) + key;
        vt[0 * (AV_PITCH / 2)] = (unsigned short)(vv.x & 0xffffu); vt[1 * (AV_PITCH / 2)] = (unsigned short)(vv.x >> 16);
        vt[2 * (AV_PITCH / 2)] = (unsigned short)(vv.y & 0xffffu); vt[3 * (AV_PITCH / 2)] = (unsigned short)(vv.y >> 16);
        vt[4 * (AV_PITCH / 2)] = (unsigned short)(vv.z & 0xffffu); vt[5 * (AV_PITCH / 2)] = (unsigned short)(vv.z >> 16);
        vt[6 * (AV_PITCH / 2)] = (unsigned short)(vv.w & 0xffffu); vt[7 * (AV_PITCH / 2)] = (unsigned short)(vv.w >> 16);
    }
    __syncthreads();
    const int rb = wid >> 2, g = wid & 3, head = kvh * 4 + g;
    const bf16_t* qp = QB + (size_t)(R0 + 32 * rb + r) * D + head * 64 + 8 * hi;
    bf16x8 qf[4];
#pragma unroll
    for (int s = 0; s < 4; ++s) qf[s] = *(const bf16x8*)(qp + 16 * s);
    f32x16 S[5];
#pragma unroll
    for (int kt = 0; kt < 5; ++kt) {
        S[kt] = (f32x16){0.f, 0.f, 0.f, 0.f, 0.f, 0.f, 0.f, 0.f, 0.f, 0.f, 0.f, 0.f, 0.f, 0.f, 0.f, 0.f};
        const LAS unsigned char* kp = lds + (32 * rb + 32 * kt + r) * AK_PITCH + 16 * hi;
#pragma unroll
        for (int s = 0; s < 4; ++s) { const bf16x8 kf = *(const LAS bf16x8*)(kp + 32 * s); S[kt] = __builtin_amdgcn_mfma_f32_32x32x16_bf16(kf, qf[s], S[kt], 0, 0, 0); }
    }
    int kmin = r + 1; { const int lim = 128 - 32 * rb - tb; kmin = kmin > lim ? kmin : lim; }
    attn_softmax(S, kmin, r + 128, sinks[head] * LOG2E, hi);
    f32x16 O0 = (f32x16){0.f, 0.f, 0.f, 0.f, 0.f, 0.f, 0.f, 0.f, 0.f, 0.f, 0.f, 0.f, 0.f, 0.f, 0.f, 0.f}, O1 = O0;
#pragma unroll
    for (int kt = 0; kt < 5; ++kt)
#pragma unroll
        for (int s2 = 0; s2 < 2; ++s2) {
            const bf16x8 pa = pfrag(S[kt], s2);
            const LAS unsigned char* vp = lds + AV_OFF + r * AV_PITCH + (32 * rb + 32 * kt + 16 * s2 + 4 * hi) * 2;
            const u32x2 l0 = *(const LAS u32x2*)(vp), h0 = *(const LAS u32x2*)(vp + 16);
            const u32x2 l1 = *(const LAS u32x2*)(vp + 32 * AV_PITCH), h1 = *(const LAS u32x2*)(vp + 32 * AV_PITCH + 16);
            const u32x4 b0 = {l0.x, l0.y, h0.x, h0.y}, b1 = {l1.x, l1.y, h1.x, h1.y};
            O0 = __builtin_amdgcn_mfma_f32_32x32x16_bf16(pa, __builtin_bit_cast(bf16x8, b0), O0, 0, 0, 0);
            O1 = __builtin_amdgcn_mfma_f32_32x32x16_bf16(pa, __builtin_bit_cast(bf16x8, b1), O1, 0, 0, 0);
        }
    bf16_t* op = AO + (size_t)(R0 + 32 * rb) * D + head * 64 + r;
#pragma unroll
    for (int i = 0; i < 16; ++i) { const int q = crow(i, hi);
        op[(size_t)q * D] = (bf16_t)(cvt_pk_bf16(O0[i], 0.f) & 0xffffu); op[(size_t)q * D + 32] = (bf16_t)(cvt_pk_bf16(O1[i], 0.f) & 0xffffu); }
    __syncthreads();
}
__device__ __forceinline__ void attn_sample_task(int task, const bf16_t* QB, const bf16_t* KB, const bf16_t* VB, const float* ck, const float* cv, const float* sinks, bf16_t* AO) {
    int tid_ = threadIdx.x; asm volatile("" : "+v"(tid_));
    const int lane = tid_ & 63, r = lane & 31, hi = lane >> 5;
    const int s = task >> 2, kvh = task & 3;
    const int g = r >> 3, t = r & 7, head = kvh * 4 + g;
    const bf16_t* qp = QB + (size_t)(MP + s * 8 + t) * D + head * 64 + 8 * hi;
    bf16x8 qf[4];
#pragma unroll
    for (int q = 0; q < 4; ++q) qf[q] = *(const bf16x8*)(qp + 16 * q);
    f32x16 S[5];
#pragma unroll
    for (int kt = 0; kt < 5; ++kt) {
        S[kt] = (f32x16){0.f, 0.f, 0.f, 0.f, 0.f, 0.f, 0.f, 0.f, 0.f, 0.f, 0.f, 0.f, 0.f, 0.f, 0.f, 0.f};
#pragma unroll
        for (int q = 0; q < 4; ++q) {
            u32x4 w = {0u, 0u, 0u, 0u};
            if (kt < 4) { const float* p = ck + ((size_t)(s * 128 + 32 * kt + r) * 4 + kvh) * 64 + 16 * q + 8 * hi; const f32x4 a = *(const f32x4*)p, b = *(const f32x4*)(p + 4);
                w.x = cvt_pk_bf16(a[0], a[1]); w.y = cvt_pk_bf16(a[2], a[3]); w.z = cvt_pk_bf16(b[0], b[1]); w.w = cvt_pk_bf16(b[2], b[3]); }
            else if (r < 8) w = *(const u32x4*)(KB + (size_t)(MP + s * 8 + r) * 256 + kvh * 64 + 16 * q + 8 * hi);
            S[kt] = __builtin_amdgcn_mfma_f32_32x32x16_bf16(__builtin_bit_cast(bf16x8, w), qf[q], S[kt], 0, 0, 0);
        }
    }
    attn_softmax(S, t + 1, t + 128, sinks[head] * LOG2E, hi);
    f32x16 O0 = (f32x16){0.f, 0.f, 0.f, 0.f, 0.f, 0.f, 0.f, 0.f, 0.f, 0.f, 0.f, 0.f, 0.f, 0.f, 0.f, 0.f}, O1 = O0;
#pragma unroll
    for (int kt = 0; kt < 5; ++kt)
#pragma unroll
        for (int s2 = 0; s2 < 2; ++s2) {
            if (kt == 4 && s2 == 1) continue;
            const bf16x8 pa = pfrag(S[kt], s2);
            float v0[8], v1[8];
#pragma unroll
            for (int j = 0; j < 8; ++j) {
                const int kk = 32 * kt + 16 * s2 + 8 * (j >> 2) + 4 * hi + (j & 3);
                if (kt < 4) { const float* p = cv + ((size_t)(s * 128 + kk) * 4 + kvh) * 64 + r; v0[j] = p[0]; v1[j] = p[32]; }
                else if (j < 4) { const bf16_t* p = VB + (size_t)(MP + s * 8 + (kk - 128)) * 256 + kvh * 64 + r; v0[j] = bf2f(p[0]); v1[j] = bf2f(p[32]); }
                else { v0[j] = 0.f; v1[j] = 0.f; }
            }
            u32x4 b0, b1;
            b0.x = cvt_pk_bf16(v0[0], v0[1]); b0.y = cvt_pk_bf16(v0[2], v0[3]); b0.z = cvt_pk_bf16(v0[4], v0[5]); b0.w = cvt_pk_bf16(v0[6], v0[7]);
            b1.x = cvt_pk_bf16(v1[0], v1[1]); b1.y = cvt_pk_bf16(v1[2], v1[3]); b1.z = cvt_pk_bf16(v1[4], v1[5]); b1.w = cvt_pk_bf16(v1[6], v1[7]);
            O0 = __builtin_amdgcn_mfma_f32_32x32x16_bf16(pa, __builtin_bit_cast(bf16x8, b0), O0, 0, 0, 0);
            O1 = __builtin_amdgcn_mfma_f32_32x32x16_bf16(pa, __builtin_bit_cast(bf16x8, b1), O1, 0, 0, 0);
        }
#pragma unroll
    for (int i = 0; i < 16; ++i) { const int q = crow(i, hi), gq = q >> 3, tq = q & 7;
        bf16_t* op = AO + (size_t)(MP + s * 8 + tq) * D + (kvh * 4 + gq) * 64 + r;
        op[0] = (bf16_t)(cvt_pk_bf16(O0[i], 0.f) & 0xffffu); op[32] = (bf16_t)(cvt_pk_bf16(O1[i], 0.f) & 0xffffu); }
}

__device__ __forceinline__ float wave_sum(float v) {
#pragma unroll
    for (int o = 1; o < 64; o <<= 1) v += __shfl_xor(v, o);
    return v;
}
__device__ __forceinline__ unsigned f2bf(float f) { unsigned u = __builtin_bit_cast(unsigned, f); return (u + 0x7fffu + ((u >> 16) & 1u)) >> 16; }
__device__ __forceinline__ unsigned pk2(float lo, float hi) { return f2bf(lo) | (f2bf(hi) << 16); }
__device__ __forceinline__ void transpose_item(const float* W, int K, int N, int k0, int n0, bf16_t* WT, int dr0, LAS float* scr, int lane) {
#pragma unroll 8
    for (int i = 0; i < 32; ++i) { const int kk = 2 * i + (lane >> 5); scr[kk * 33 + (lane & 31)] = W[(size_t)(k0 + kk) * N + n0 + (lane & 31)]; }
    asm volatile("s_waitcnt lgkmcnt(0)" ::: "memory");
    const int c = lane & 7;
#pragma unroll
    for (int j = 0; j < 4; ++j) { const int n = (lane >> 3) + 8 * j; const LAS float* s = scr + (8 * c) * 33 + n;
        u32x4 o; o.x = pk2(s[0 * 33], s[1 * 33]); o.y = pk2(s[2 * 33], s[3 * 33]); o.z = pk2(s[4 * 33], s[5 * 33]); o.w = pk2(s[6 * 33], s[7 * 33]);
        *(u32x4*)(WT + (size_t)(dr0 + n) * K + k0 + 8 * c) = o; }
    asm volatile("s_waitcnt lgkmcnt(0)" ::: "memory");
}

#ifndef PH_MASK
#define PH_MASK 0xFFFFFFFFu
#endif
#define PH(k) (((PH_MASK) >> (k)) & 1u)
__device__ __constant__ const float INV_FREQ[8] = {1.0f, 0.1939227432012558f, 0.03760603070259094f, 0.007292664609849453f, 0.0014142135623842478f, 0.00027424818836152554f, 5.318296098266728e-05f, 1.0313386155758053e-05f};

__global__ void __launch_bounds__(512, 2) mega_fwd(Args args) {
    extern __shared__ __attribute__((aligned(16))) unsigned char lds_raw[];
    LAS unsigned char* lds = (LAS unsigned char*)lds_raw;
#define LANE_IDS() int tid = threadIdx.x; asm volatile("" : "+v"(tid)); const int lane = tid & 63, wave = __builtin_amdgcn_readfirstlane(tid >> 6); int vcu_ = vcu; asm volatile("" : "+s"(vcu_)); const int gw = vcu_ * 8 + wave, NGW = G * 8; (void)lane; (void)gw; (void)NGW
    const int G = gridDim.x, bx = blockIdx.x;
    const int vcu = (G % 8 == 0) ? (bx % 8) * (G / 8) + bx / 8 : bx;
    KArgP ap = (KArgP)__builtin_amdgcn_kernarg_segment_ptr();
#define REFRESH() asm volatile("" : "+s"(ap))
#define IN(i) (ap->in[i])
#define ws (ap->ws)
#define out (ap->out)
#define x_prompt IN(0)
#define x_sample IN(1)
#define state_conv IN(2)
#define cache_k IN(3)
#define cache_v IN(4)
#define c_prompt IN(5)
#define c_sample IN(6)
#define norm_g IN(7)
#define w_ada IN(8)
#define b_ada IN(9)
#define w_gate IN(10)
#define w_up IN(11)
#define w_down IN(12)
#define conv_w_in IN(13)
#define conv_w IN(14)
#define conv_w_out IN(15)
#define kv_norm_g IN(16)
#define w_ada_kv IN(17)
#define b_ada_kv IN(18)
#define w_k IN(19)
#define w_v IN(20)
#define attn_w_q IN(21)
#define sinks IN(22)
#define attn_w_o IN(23)
#define final_g IN(24)
#define W_UP ((bf16_t*)(ws + WS_WUP))
#define W_DN ((bf16_t*)(ws + WS_WDN))
#define W_IN ((bf16_t*)(ws + WS_WIN))
#define W_OUT ((bf16_t*)(ws + WS_WOUT))
#define W_Q ((bf16_t*)(ws + WS_WQ))
#define W_O ((bf16_t*)(ws + WS_WO))
#define W_KV ((bf16_t*)(ws + WS_WKV))
#define W_ADA ((bf16_t*)(ws + WS_WADA))
#define BIASW ((float*)(ws + WS_BIASW))
#define KB ((bf16_t*)(ws + WS_KB))
#define VB ((bf16_t*)(ws + WS_VB))
#define MODSF ((float*)(ws + WS_MODSF))
#define MODSB ((bf16_t*)(ws + WS_MODSB))
#define AC ((bf16_t*)(ws + WS_AC))
#define ROPE ((float*)(ws + WS_ROPE))
#define AP ((bf16_t*)(ws + WS_AP))
#define AQ ((bf16_t*)(ws + WS_AQ))
#define ACT ((bf16_t*)(ws + WS_ACT))
#define UB ((bf16_t*)(ws + WS_U))
#define ZB ((bf16_t*)(ws + WS_Z))
#define QB ((bf16_t*)(ws + WS_QB))
#define AO ((bf16_t*)(ws + WS_AO))
#define SSQ(k) ((float*)(ws + WS_SSQ + (size_t)(k) * SSQ_BYTES))

    for (int u = threadIdx.x; u < (LDS_BYTES - RING_BYTES) / 4; u += 512) ((LAS unsigned*)(lds + RING_BYTES))[u] = 0u;
    __syncthreads();
    volatile LAS unsigned* MISC = (volatile LAS unsigned*)(lds + MISC_OFF);
    XcdBarrier bar = xcd_barrier_post((unsigned*)(ws + WS_CTL) + CW_BAR, MISC + 8);
#define GRID_BAR() xcd_barrier(bar)

    if (PH(20))
    {
        LANE_IDS();
        LAS float* scr = (LAS float*)(lds + wave * 16384);
        constexpr int I_G = 16 * 88, I_D = 44 * 32, I_IN = 16 * 96, I_SQ = 16 * 32, I_KV = 16 * 8, I_ADA = 16 * 288, I_AKV = 16 * 64;
        constexpr int NITEMS = 12 * I_G + I_IN + 3 * I_SQ + 2 * I_KV + 2 * I_ADA + I_AKV;
        static_assert(I_G == I_D, "items");
        for (int it = gw; it < NITEMS; it += NGW) {
            REFRESH();
            int r = it;
            if (r < 8 * I_G) {
                const int mat = r / I_G, q = r % I_G, li = mat >> 1, isup = mat & 1, kb = q / 88, nb = q % 88, n0 = 32 * nb;
                const float* W = (isup ? w_up : w_gate) + (size_t)li * D * FF;
                transpose_item(W, D, FF, 64 * kb, n0, W_UP + (size_t)li * 5632 * D, (n0 >> 7) * 256 + isup * 128 + (n0 & 127), scr, lane); continue; }
            r -= 8 * I_G;
            if (r < 4 * I_D) { const int li = r / I_D, q = r % I_D, kb = q / 32, nb = q % 32;
                transpose_item(w_down + (size_t)li * FF * D, FF, D, 64 * kb, 32 * nb, W_DN + (size_t)li * D * FF, 32 * nb, scr, lane); continue; }
            r -= 4 * I_D;
            if (r < I_IN) { const int kb = r / 96, nb = r % 96, n0 = 32 * nb, part = n0 >> 10, nn = n0 & 1023;
                const int dr = (part == 0) ? 2048 + nn : (nn >> 7) * 256 + (part == 2 ? 128 : 0) + (nn & 127);
                transpose_item(conv_w_in, D, 3 * D, 64 * kb, n0, W_IN, dr, scr, lane); continue; }
            r -= I_IN;
            if (r < 3 * I_SQ) { const int mat = r / I_SQ, q = r % I_SQ, kb = q / 32, nb = q % 32;
                const float* W = mat == 0 ? conv_w_out : (mat == 1 ? attn_w_q : attn_w_o); bf16_t* WT = mat == 0 ? W_OUT : (mat == 1 ? W_Q : W_O);
                transpose_item(W, D, D, 64 * kb, 32 * nb, WT, 32 * nb, scr, lane); continue; }
            r -= 3 * I_SQ;
            if (r < 2 * I_KV) { const int mat = r / I_KV, q = r % I_KV, kb = q / 8, nb = q % 8;
                transpose_item(mat ? w_v : w_k, D, 256, 64 * kb, 32 * nb, W_KV, mat * 256 + 32 * nb, scr, lane); continue; }
            r -= 2 * I_KV;
            if (r < 2 * I_ADA) { const int li = r / I_ADA, q = r % I_ADA, kb = q / 288, nb = q % 288;
                transpose_item(w_ada + (size_t)li * D * 9216, D, 9216, 64 * kb, 32 * nb, W_ADA, li * 9216 + 32 * nb, scr, lane); continue; }
            r -= 2 * I_ADA;
            { const int kb = r / 64, nb = r % 64; transpose_item(w_ada_kv, D, 2048, 64 * kb, 32 * nb, W_ADA, 18432 + 32 * nb, scr, lane); }
        }
        const int gt = vcu_ * 512 + tid, NGT = G * 512;
        REFRESH();
        for (int i = gt; i < 256 * D / 4; i += NGT) {
            const int row = i >> 8, c4 = (i & 255) * 4;
            u32x2 w = {0u, 0u};
            if (row < NSEQ) { const float* src = row < 2 ? c_prompt + (size_t)row * D : c_sample + (size_t)(row - 2) * D; const f32x4 v = *(const f32x4*)(src + c4);
                w.x = pk2(silu_f(v[0]), silu_f(v[1])); w.y = pk2(silu_f(v[2]), silu_f(v[3])); }
            *(u32x2*)(AC + (size_t)row * D + c4) = w;
        }
        REFRESH();
        for (int i = gt; i < MT * 8; i += NGT) {
            const int row = i >> 3, k = i & 7;
            const int pos = row < MP ? (row & (SEQ - 1)) : PAST + ((row - MP) & 7);
            const float ang = (float)pos * INV_FREQ[k];
            const double a = (double)ang, kd = __builtin_rint(a * 0.6366197723675814);
            double rr = __builtin_fma(-kd, 1.5707963267948966, a); rr = __builtin_fma(-kd, 6.123233995736766e-17, rr);
            const double r2 = rr * rr;
            const double sn = rr * (1.0 + r2 * (-1.0 / 6 + r2 * (1.0 / 120 + r2 * (-1.0 / 5040 + r2 * (1.0 / 362880 + r2 * (-1.0 / 39916800 + r2 * (1.0 / 6227020800.0)))))));
            const double cs = 1.0 + r2 * (-0.5 + r2 * (1.0 / 24 + r2 * (-1.0 / 720 + r2 * (1.0 / 40320 + r2 * (-1.0 / 3628800 + r2 * (1.0 / 479001600.0))))));
            const int q = ((int)kd) & 3;
            const double s_ = (q == 0) ? sn : (q == 1) ? cs : (q == 2) ? -sn : -cs;
            const double c_ = (q == 0) ? cs : (q == 1) ? -sn : (q == 2) ? -cs : sn;
            ROPE[(size_t)row * 16 + k] = (float)c_; ROPE[(size_t)row * 16 + 8 + k] = (float)s_;
        }
        REFRESH();
        for (int i = gt; i < 128 * 120 * 64; i += NGT) {
            const int s = i / (120 * 64), rem = i % (120 * 64), rw = rem >> 6, c4 = (rem & 63) * 4;
            const size_t src = ((size_t)(s * 128 + rw + 8)) * 256 + c4, dst = ((size_t)(s * 128 + rw)) * 256 + c4;
            *(f32x4*)(out + O_KS + dst) = *(const f32x4*)(cache_k + src);
            *(f32x4*)(out + O_VS + dst) = *(const f32x4*)(cache_v + src);
        }
    }
    GRID_BAR();
    REFRESH();
    if (PH(21)) {
        pg8::Gemm g{AC, W_ADA, 256, MODW, D, D}; pg8::StaticOrder S; S.init(256, MODW, G, bx);
        EpiAda E{ap};
        pg8::gemm_phase<EpiAda, pg8::StaticOrder>(lds, g, S, E);
    }
    GRID_BAR();
    REFRESH();
    if (PH(22)) {
        int cstart = 0;
#define BW_SITE(shoff, Wt, Ncols, bwoff) do { REFRESH(); int bxs = bx; asm volatile("" : "+s"(bxs)); pg8::Gemm g{MODSB + (shoff), (Wt), 256, (Ncols), D, MODW}; pg8::StaticOrder S; S.init(256, (Ncols), G, (bxs + G - cstart) % G); \
            EpiBw E{ap, (bwoff)}; pg8::gemm_phase<EpiBw, pg8::StaticOrder>(lds, g, S, E); cstart = (cstart + (Ncols) / 256) % G; } while (0)
        BW_SITE(0, W_UP, 5632, 0);
        BW_SITE(3072, W_IN, 3072, 5632);
        BW_SITE(6144, W_UP + (size_t)1 * 5632 * D, 5632, 8704);
        BW_SITE(18432, W_KV, 512, 14336);
        BW_SITE(9216, W_UP + (size_t)2 * 5632 * D, 5632, 14848);
        BW_SITE(9216 + 3072, W_Q, 1024, 20480);
        BW_SITE(9216 + 6144, W_UP + (size_t)3 * 5632 * D, 5632, 21504);
#undef BW_SITE
        REFRESH();
        LANE_IDS();
        float* ssq0 = SSQ(0);
        for (int row = gw; row < MT; row += NGW) {
            const float* xr = row < MP ? x_prompt + (size_t)row * D : x_sample + (size_t)(row - MP) * D;
            const float* md = MODSF + (size_t)seq_of_row(row) * MODW + 1024;
            f32x4 v[4]; float s = 0.f;
#pragma unroll
            for (int j = 0; j < 4; ++j) { v[j] = *(const f32x4*)(xr + 4 * lane + 256 * j); s += (v[j][0] * v[j][0] + v[j][1] * v[j][1]) + (v[j][2] * v[j][2] + v[j][3] * v[j][3]); }
            s = wave_sum(s);
#pragma unroll
            for (int j = 0; j < 4; ++j) { const int col = 4 * lane + 256 * j;
                const f32x4 a = v[j] * (*(const f32x4*)(norm_g + col)) * (*(const f32x4*)(md + col) + 1.0f);
                u32x2 w; w.x = cvt_pk_bf16(a[0], a[1]); w.y = cvt_pk_bf16(a[2], a[3]); *(u32x2*)(AP + (size_t)row * D + col) = w; }
            if (lane < 16) ssq0[(size_t)row * 16 + lane] = (lane == 0) ? s : 0.f;
        }
    }
    GRID_BAR();
    for (int step = 0; step < 15; ++step) {
        REFRESH();
        int bxs = bx; asm volatile("" : "+s"(bxs));
        LANE_IDS();
        if (PH(0) && (step == 0 || step == 5 || step == 12)) {
            const int widx = step == 0 ? 0 : (step == 5 ? 1 : 3);
            const int bwoff = step == 0 ? 0 : (step == 5 ? 8704 : 21504);
            const int sq = step == 0 ? 0 : (step == 5 ? 2 : 5);
            pg8::Gemm g{step == 12 ? AQ : AP, W_UP + (size_t)widx * 5632 * D, MT, 5632, D, D}; pg8::StaticOrder S; S.init(MT, 5632, G, bxs);
            EpiUp E{ap, sq, bwoff};
            pg8::gemm_phase<EpiUp, pg8::StaticOrder>(lds, g, S, E);
        } else if (PH(7) && step == 7) {
            { pg8::Gemm g{AP, W_KV, MT, 512, D, D}; pg8::StaticOrder S; S.init(MT, 512, G, (bxs + G - 216) % G);
              EpiKV E{ap};
              pg8::gemm_phase<EpiKV, pg8::StaticOrder>(lds, g, S, E); }
            REFRESH();
            { pg8::Gemm g{AQ, W_UP + (size_t)2 * 5632 * D, MT, 5632, D, D}; pg8::StaticOrder S; S.init(MT, 5632, G, bxs);
              EpiUp E{ap, 3, 14848};
              pg8::gemm_phase<EpiUp, pg8::StaticOrder>(lds, g, S, E); }
        } else if (PH(1) && (step == 1 || step == 4 || step == 6 || step == 8 || step == 11 || step == 13)) {
            EpiRes E{ap, step}; pg8::Gemm g;
            if (step == 1)       g = pg8::Gemm{ACT, W_DN, MT, D, FF, FF};
            else if (step == 4)  g = pg8::Gemm{ZB, W_OUT, MT, D, D, D};
            else if (step == 6)  g = pg8::Gemm{ACT, W_DN + (size_t)1 * D * FF, MT, D, FF, FF};
            else if (step == 8)  g = pg8::Gemm{ACT, W_DN + (size_t)2 * D * FF, MT, D, FF, FF};
            else if (step == 11) g = pg8::Gemm{AO, W_O, MT, D, D, D};
            else                 g = pg8::Gemm{ACT, W_DN + (size_t)3 * D * FF, MT, D, FF, FF};
            pg8::StaticOrder S; S.init(MT, D, G, bxs);
            pg8::gemm_phase<EpiRes, pg8::StaticOrder>(lds, g, S, E);
        } else if (PH(2) && step == 2) {
            pg8::Gemm g{AQ, W_IN, MT, 2048, D, D}; pg8::StaticOrder S; S.init(MT, 2048, G, bxs);
            EpiU E{ap};
            pg8::gemm_phase<EpiU, pg8::StaticOrder>(lds, g, S, E);
        } else if (PH(3) && step == 3) {
            pg8::Gemm g{AQ, W_IN + (size_t)2048 * D, MT, D, D, D}; pg8::StaticOrder S; S.init(MT, D, G, bxs);
            EpiBg E{ap};
            pg8::gemm_phase<EpiBg, pg8::StaticOrder>(lds, g, S, E);
        } else if (PH(9) && step == 9) {
            pg8::Gemm g{AP, W_Q, MT, D, D, D}; pg8::StaticOrder S; S.init(MT, D, G, bxs);
            EpiQ E{ap};
            pg8::gemm_phase<EpiQ, pg8::StaticOrder>(lds, g, S, E);
        } else if (PH(10) && step == 10) {
            for (int un = vcu_; un < 1088; un += G) {
                if (un < 1024) attn_prompt_unit(lds, un, QB, KB, VB, sinks, AO);
                else attn_sample_task((un - 1024) * 8 + wave, QB, KB, VB, cache_k, cache_v, sinks, AO);
            }
        } else if (PH(14) && step == 14) {
            const float* ssq6 = SSQ(6);
            for (int row = gw; row < MT; row += NGW) {
                const float rs = row_rstd(ssq6, row);
                float* yr = out + O_Y + (size_t)row * D;
#pragma unroll
                for (int j = 0; j < 4; ++j) { const int col = 4 * lane + 256 * j; *(f32x4*)(yr + col) = *(const f32x4*)(yr + col) * rs * (*(const f32x4*)(final_g + col)); }
            }
        }
        if (step < 14) GRID_BAR();
    }
}

#undef REFRESH
#undef LANE_IDS
#undef IN
#undef ws
#undef out
#undef x_prompt
#undef x_sample
#undef state_conv
#undef cache_k
#undef cache_v
#undef c_prompt
#undef c_sample
#undef norm_g
#undef w_ada
#undef b_ada
#undef w_gate
#undef w_up
#undef w_down
#undef conv_w_in
#undef conv_w
#undef conv_w_out
#undef kv_norm_g
#undef w_ada_kv
#undef b_ada_kv
#undef w_k
#undef w_v
#undef attn_w_q
#undef sinks
#undef attn_w_o
#undef final_g
#undef W_UP
#undef W_DN
#undef W_IN
#undef W_OUT
#undef W_Q
#undef W_O
#undef W_KV
#undef W_ADA
#undef BIASW
#undef KB
#undef VB
#undef MODSF
#undef MODSB
#undef AC
#undef ROPE
#undef AP
#undef AQ
#undef ACT
#undef UB
#undef ZB
#undef QB
#undef AO
extern "C" void kernel_launch(void* const* d_in, const int* in_sizes, int n_in, void* d_out, int out_size, void* d_ws, size_t ws_size, hipStream_t stream) {
    static int grid = 0;
    if (grid == 0) {
        if (n_in != 25 || ws_size < WS_END) { fprintf(stderr, "kernel_launch: need 25 inputs and >= %zu bytes of workspace; got %d inputs, %zu bytes\n", (size_t)WS_END, n_in, ws_size); grid = -1; return; }
        int dev = 0, cus = 0, per_cu = 0;
        if (hipGetDevice(&dev) != hipSuccess || hipDeviceGetAttribute(&cus, hipDeviceAttributeMultiprocessorCount, dev) != hipSuccess) { grid = -1; return; }
        if (hipFuncSetAttribute((const void*)mega_fwd, hipFuncAttributeMaxDynamicSharedMemorySize, LDS_BYTES) != hipSuccess) { fprintf(stderr, "kernel_launch: hipFuncSetAttribute failed\n"); grid = -1; return; }
        if (hipOccupancyMaxActiveBlocksPerMultiprocessor(&per_cu, (const void*)mega_fwd, 512, LDS_BYTES) != hipSuccess || per_cu < 1) { fprintf(stderr, "kernel_launch: occupancy query says %d blocks per CU\n", per_cu); (void)hipGetLastError(); grid = -1; return; }
        grid = cus;
    }
    if (grid < 0) return;
    (void)hipMemsetAsync((char*)d_ws + WS_CTL, 0, CTL_ZERO_BYTES, stream);
    Args a{};
    for (int i = 0; i < 25; ++i) a.in[i] = (const float*)d_in[i];
    a.out = (float*)d_out; a.ws = (unsigned char*)d_ws;
    void* kargs[] = {&a};
    hipError_t e = hipLaunchCooperativeKernel((const void*)mega_fwd, dim3(grid), dim3(512), kargs, LDS_BYTES, stream);
    if (e != hipSuccess) fprintf(stderr, "kernel_launch: cooperative launch failed: %s (grid %d)\n", hipGetErrorString(e), grid);
}
```
